# Optimizing an MI355X kernel written in HIP

```python
import math
import jax, jax.numpy as jnp
from jax import lax
import numpy as np

D_MODEL = 1024
BATCH = 32
SEQ = 256
DEPTH = 4
DEC_BATCH = 4
DEC_SEQ = 4096
PAST_LEN = 512

GRID_W = 64
N_MIXERS = 3
LAYER_KIND = tuple(i % N_MIXERS for i in range(DEPTH))
N_A = LAYER_KIND.count(0)
N_B = LAYER_KIND.count(1)
N_C = LAYER_KIND.count(2)

E_A = 2 * D_MODEL
POOL_WINDOWS = (2, 4, 8, 16)
N_POOL_GROUPS = len(POOL_WINDOWS)
G_A = E_A // N_POOL_GROUPS
E_B = 2 * D_MODEL
CHUNK = 128
H_B = 8
DH_B = E_B // H_B
H_C = 16
DH_C = 64
E_C = H_C * DH_C
WIN_R_MAX = 8
WIN_C = 16

DEEPNORM_ALPHA = (2 * DEPTH) ** 0.25
DEEPNORM_BETA = (8 * DEPTH) ** -0.25
LN_EPS = 1e-5

kernel_name = "hybrid_pool_gmlp_natten_diffusion_step"


def layer_norm(x, g, b):
    xf = x.astype(jnp.float32)
    mu = jnp.mean(xf, axis=-1, keepdims=True)
    var = jnp.mean(jnp.square(xf - mu), axis=-1, keepdims=True)
    y = (xf - mu) * lax.rsqrt(var + LN_EPS)
    return (y * g.astype(jnp.float32) + b.astype(jnp.float32)).astype(x.dtype)


def adaln(cond, w_mod, b_mod):
    m = jax.nn.silu(cond) @ w_mod + b_mod
    shift, scale, gate = jnp.split(m[:, None, :], 3, axis=-1)
    return shift, scale, gate


def centred_mean_minus_self(x, w):
    L = x.shape[1]
    xf = x.astype(jnp.float32)
    cs = jnp.concatenate([jnp.zeros_like(xf[:, :1]), jnp.cumsum(xf, axis=1)], axis=1)
    t = jnp.arange(L)
    lo = jnp.clip(t - w // 2, 0, L - 1)
    hi = jnp.clip(t + w // 2 - 1, 0, L - 1)
    cnt = (hi - lo + 1).astype(jnp.float32)[None, :, None]
    return ((cs[:, hi + 1] - cs[:, lo]) / cnt - xf).astype(x.dtype)


def pool_mixer(h, w_in, w_grp, scale, w_out):
    z = h @ w_in
    xb, gate = jnp.split(z, 2, axis=-1)
    groups = jnp.split(xb, N_POOL_GROUPS, axis=-1)
    mixed = [centred_mean_minus_self(g, w) @ w_grp[i] for i, (g, w) in enumerate(zip(groups, POOL_WINDOWS))]
    y = jnp.concatenate(mixed, axis=-1) * scale * jax.nn.silu(gate)
    return y @ w_out


def chunk_mlp_mixer(h, w_in, ln_g, ln_b, w_s, b_s, w_out):
    bsz, L, _ = h.shape
    z = h @ w_in
    u, v, gate = jnp.split(z, 3, axis=-1)
    u = jax.nn.gelu(u)
    v = layer_norm(jax.nn.gelu(v), ln_g, ln_b)
    v = v.reshape(bsz, L // CHUNK, CHUNK, H_B, DH_B)
    v = jnp.einsum('hpq,bnqhd->bnphd', w_s, v) + b_s.T[None, None, :, :, None]
    y = u * v.reshape(bsz, L, E_B) * jax.nn.silu(gate)
    return y @ w_out


def na_project(h, w_in):
    z = h @ w_in
    q, k, v, gate = jnp.split(z, 4, axis=-1)
    sh = h.shape[:2] + (H_C, DH_C)
    return q.reshape(sh), k.reshape(sh), v.reshape(sh), gate


def context_attention(h, w_in, w_out):
    bsz, L, _ = h.shape
    q, k, v, gate = na_project(h, w_in)
    logits = jnp.einsum('bqhd,bkhd->bhqk', q, k).astype(jnp.float32) * (DH_C ** -0.5)
    p = jax.nn.softmax(logits, axis=-1).astype(v.dtype)
    o = jnp.einsum('bhqk,bkhd->bqhd', p, v).reshape(bsz, L, E_C)
    return (o * jax.nn.silu(gate)) @ w_out, k, v


def latent_neighbourhood_attention(h, k_ctx, v_ctx, w_in, rpb, w_out):
    bsz, L, _ = h.shape
    rows = L // GRID_W
    kr = min(WIN_R_MAX, rows)
    q, k, v, gate = na_project(h, w_in)
    qg = q.reshape(bsz, rows, GRID_W, H_C, DH_C)
    kg = k.reshape(bsz, rows, GRID_W, H_C, DH_C)
    vg = v.reshape(bsz, rows, GRID_W, H_C, DH_C)
    col = jnp.arange(GRID_W)
    c0 = jnp.clip(col - WIN_C // 2, 0, GRID_W - WIN_C)
    col_in = (col[None, :] >= c0[:, None]) & (col[None, :] < c0[:, None] + WIN_C)
    dc_idx = jnp.clip(col[None, :] - col[:, None] + WIN_C - 1, 0, 2 * WIN_C - 2)
    rpb_cols = rpb.astype(jnp.float32)[:, :, dc_idx]
    mask = jnp.tile(col_in, (1, kr))
    scale = DH_C ** -0.5
    nb = kr * GRID_W

    def row_block(r):
        r0 = jnp.clip(r - kr // 2, 0, rows - kr)
        q_r = lax.dynamic_index_in_dim(qg, r, axis=1, keepdims=False)
        k_band = lax.dynamic_slice_in_dim(kg, r0, kr, axis=1).reshape(bsz, nb, H_C, DH_C)
        v_band = lax.dynamic_slice_in_dim(vg, r0, kr, axis=1).reshape(bsz, nb, H_C, DH_C)
        dr_idx = r0 + jnp.arange(kr) - r + WIN_R_MAX - 1
        bias = jnp.take(rpb_cols, dr_idx, axis=1)
        bias = bias.transpose(0, 2, 1, 3).reshape(H_C, GRID_W, nb)
        lg_band = jnp.einsum('bqhd,bkhd->bhqk', q_r, k_band).astype(jnp.float32) * scale + bias
        lg_band = jnp.where(mask, lg_band, -jnp.inf)
        lg_ctx = jnp.einsum('bqhd,bkhd->bhqk', q_r, k_ctx).astype(jnp.float32) * scale
        p = jax.nn.softmax(jnp.concatenate([lg_band, lg_ctx], axis=-1), axis=-1).astype(v.dtype)
        return (jnp.einsum('bhqk,bkhd->bqhd', p[..., :nb], v_band)
                + jnp.einsum('bhqk,bkhd->bqhd', p[..., nb:], v_ctx))

    o = lax.map(row_block, jnp.arange(rows))
    o = jnp.moveaxis(o, 0, 1).reshape(bsz, L, E_C)
    return (o * jax.nn.silu(gate)) @ w_out


def setup_inputs(seed: int = 0) -> dict:
    key = jax.random.key(seed)
    ks = jax.random.split(key, 24)
    nrm = jax.random.normal
    f32 = jnp.float32
    D = D_MODEL
    na_w_in = nrm(ks[20], (N_C, D, 4 * E_C), f32) * D ** -0.5
    na_w_in = na_w_in.at[..., 2 * E_C:3 * E_C].multiply(DEEPNORM_BETA)
    return {
        'x_prompt': nrm(ks[0], (BATCH, SEQ, D), f32),
        'x_sample': nrm(ks[1], (DEC_BATCH, DEC_SEQ, D), f32),
        'c': nrm(ks[2], (DEC_BATCH, D), f32),
        'cache_k': nrm(ks[3], (DEC_BATCH, N_C, PAST_LEN, H_C, DH_C), f32),
        'cache_v': nrm(ks[4], (DEC_BATCH, N_C, PAST_LEN, H_C, DH_C), f32) * DEEPNORM_BETA,
        'c_ctx': nrm(ks[5], (D,), f32),
        'w_mod': nrm(ks[6], (DEPTH, D, 3 * D), f32) * D ** -0.5,
        'b_mod': nrm(ks[7], (DEPTH, 3 * D), f32) * 0.02,
        'ln_g': 1.0 + 0.02 * nrm(ks[8], (DEPTH, D), f32),
        'ln_b': 0.02 * nrm(ks[9], (DEPTH, D), f32),
        'pool_w_in': nrm(ks[10], (N_A, D, 2 * E_A), f32) * D ** -0.5,
        'pool_w_grp': nrm(ks[11], (N_A, N_POOL_GROUPS, G_A, G_A), f32) * G_A ** -0.5,
        'pool_scale': 1.0 + 0.1 * nrm(ks[12], (N_A, E_A), f32),
        'pool_w_out': nrm(ks[13], (N_A, E_A, D), f32) * (E_A ** -0.5 * DEEPNORM_BETA),
        'sgu_w_in': nrm(ks[14], (N_B, D, 3 * E_B), f32) * D ** -0.5,
        'sgu_ln_g': 1.0 + 0.02 * nrm(ks[15], (N_B, E_B), f32),
        'sgu_ln_b': 0.02 * nrm(ks[16], (N_B, E_B), f32),
        'sgu_w_s': nrm(ks[17], (N_B, H_B, CHUNK, CHUNK), f32) * CHUNK ** -0.5,
        'sgu_b_s': 1.0 + 0.02 * nrm(ks[18], (N_B, H_B, CHUNK), f32),
        'sgu_w_out': nrm(ks[19], (N_B, E_B, D), f32) * (E_B ** -0.5 * DEEPNORM_BETA),
        'na_w_in': na_w_in,
        'na_rpb': 0.1 * nrm(ks[21], (N_C, H_C, 2 * WIN_R_MAX - 1, 2 * WIN_C - 1), f32),
        'na_w_out': nrm(ks[22], (N_C, E_C, D), f32) * (E_C ** -0.5 * DEEPNORM_BETA),
    }


def reference(x_prompt, x_sample, c, cache_k, cache_v, c_ctx, w_mod, b_mod, ln_g, ln_b,
              pool_w_in, pool_w_grp, pool_scale, pool_w_out,
              sgu_w_in, sgu_ln_g, sgu_ln_b, sgu_w_s, sgu_b_s, sgu_w_out,
              na_w_in, na_rpb, na_w_out):
    yp = x_prompt
    ys = x_sample
    ctx_cond = c_ctx[None, :]
    ks_new, vs_new = [], []
    for i in range(DEPTH):
        kind = LAYER_KIND[i]
        j = i // N_MIXERS
        sp, scp, gp = adaln(ctx_cond, w_mod[i], b_mod[i])
        ss, scs, gs = adaln(c, w_mod[i], b_mod[i])
        hp = yp * (1.0 + scp) + sp
        hs = ys * (1.0 + scs) + ss
        if kind == 0:
            op = pool_mixer(hp, pool_w_in[j], pool_w_grp[j], pool_scale[j], pool_w_out[j])
            osm = pool_mixer(hs, pool_w_in[j], pool_w_grp[j], pool_scale[j], pool_w_out[j])
        elif kind == 1:
            op = chunk_mlp_mixer(hp, sgu_w_in[j], sgu_ln_g[j], sgu_ln_b[j], sgu_w_s[j], sgu_b_s[j], sgu_w_out[j])
            osm = chunk_mlp_mixer(hs, sgu_w_in[j], sgu_ln_g[j], sgu_ln_b[j], sgu_w_s[j], sgu_b_s[j], sgu_w_out[j])
        else:
            op, kp, vp = context_attention(hp, na_w_in[j], na_w_out[j])
            ks_new.append(kp)
            vs_new.append(vp)
            osm = latent_neighbourhood_attention(hs, cache_k[:, j], cache_v[:, j], na_w_in[j], na_rpb[j], na_w_out[j])
        yp = layer_norm(DEEPNORM_ALPHA * yp + gp * op, ln_g[i], ln_b[i])
        ys = layer_norm(DEEPNORM_ALPHA * ys + gs * osm, ln_g[i], ln_b[i])
    ctx_k = jnp.stack(ks_new, axis=1)
    ctx_v = jnp.stack(vs_new, axis=1)
    return (yp, ys, ctx_k, ctx_v)
```

```cpp
#include <hip/hip_runtime.h>
#include <cstdio>
#include <cstdint>
#include <cmath>

#define LAS __attribute__((address_space(3)))
#define GAS __attribute__((address_space(1)))
typedef unsigned short bf16_t;
typedef short bf16x8 __attribute__((ext_vector_type(8)));
typedef short s16x4 __attribute__((ext_vector_type(4)));
typedef float f32x2 __attribute__((ext_vector_type(2)));
typedef float f32x4 __attribute__((ext_vector_type(4)));
typedef float f32x16 __attribute__((ext_vector_type(16)));
typedef unsigned u32x2 __attribute__((ext_vector_type(2)));
typedef unsigned u32x4 __attribute__((ext_vector_type(4)));

constexpr int D = 1024, TP = 8192, TS = 16384, T = TP + TS;
constexpr float ALPHA = 1.681792830507429f, LN_EPS = 1e-5f, LOG2E = 1.4426950408889634f;
constexpr size_t MiB = 1u << 20;
constexpr int NWAVES = 8;

__device__ __forceinline__ unsigned cvt_pk_bf16(float lo, float hi) { unsigned r; asm volatile("v_cvt_pk_bf16_f32 %0, %1, %2" : "=v"(r) : "v"(lo), "v"(hi)); return r; }
__device__ __forceinline__ float bf2f(unsigned short b) { return __uint_as_float(((unsigned)b) << 16); }
__device__ __forceinline__ float bflo(unsigned w) { return __uint_as_float(w << 16); }
__device__ __forceinline__ float bfhi(unsigned w) { return __uint_as_float(w & 0xffff0000u); }
__device__ __forceinline__ float fast_sigmoid(float x) { return __builtin_amdgcn_rcpf(1.f + __builtin_amdgcn_exp2f(-LOG2E * x)); }
__device__ __forceinline__ float silu_f(float x) { return x * fast_sigmoid(x); }
__device__ __forceinline__ float gelu_f(float x) { const float u = x * (1.f + 0.044715f * x * x); return x * fast_sigmoid(1.5957691216057308f * u); }
#define LDS_WAIT() asm volatile("s_waitcnt lgkmcnt(0)" ::: "memory")
#define VM_WAIT() asm volatile("s_waitcnt vmcnt(0)" ::: "memory")
namespace pg8 {
constexpr int BM = 256, BK = 64, HALF = 128, HTB = HALF * BK * 2  , STAGE_BYTES = 8 * HTB, NXCD = 8, WGM = 8;

__host__ __device__ __forceinline__ int lds_byte(int r, int c) { const int st = (r >> 4) * 2 + (c >> 5), rr = r & 15, cc = c & 31, ob = rr * 64 + cc * 2; return st * 1024 + (ob ^ (((ob >> 9) & 1) << 5)); }
__host__ __device__ __forceinline__ void stage_rc(int b, int& R, int& C) { const int st = b / 1024, sb = b % 1024, swz = sb ^ (((sb >> 9) & 1) << 5); R = (st >> 1) * 16 + swz / 64; C = (st & 1) * 32 + (swz % 64) / 2; }
__host__ __device__ __forceinline__ int perm32(int rho) { const int n = rho >> 4, i = rho & 15; return 8 * (i >> 2) + 4 * n + (i & 3); }

struct Unit { int pm, pn, job; const char* a; const char* b; };
struct Gemm { const bf16_t* A; const bf16_t* Bt; int M, N, K, lda, ldb; };

struct StaticOrder {
    int nM, nN, nwg, G, c; const char* A; const char* Bt; size_t ta, tb;
    __device__ void init(const Gemm& g, int G_, int c_) { nM = g.M / BM; nN = g.N / BM; nwg = nM * nN; G = G_; c = c_; A = (const char*)g.A; Bt = (const char*)g.Bt; ta = (size_t)BM * g.lda * 2; tb = (size_t)BM * g.ldb * 2; }
    __device__ bool next(int i, Unit& u) const {
        const long L = (long)i * G + c; if (L >= nwg) return false;
        int wgid = (int)L; { const int q = nwg / NXCD, r = nwg % NXCD, xcd = wgid % NXCD, off = wgid / NXCD; wgid = (xcd < r ? xcd * (q + 1) : r * (q + 1) + (xcd - r) * q) + off; }
        const int nig = WGM * nN, gid = wgid / nig, fm = gid * WGM, gsz = (nM - fm) < WGM ? (nM - fm) : WGM;
        u.pm = fm + ((wgid % nig) % gsz); u.pn = (wgid % nig) / gsz; u.job = 0; u.a = A + (size_t)u.pm * ta; u.b = Bt + (size_t)u.pn * tb; return true;
    }
};

template <class Epi, class Sched, bool ALIGN_EPI = true>
__device__ __forceinline__ void gemm_phase(LAS unsigned char* lds, const int K, const int lda, const int ldb, const Sched& S, const Epi& E) {
    int tid_ = threadIdx.x; asm volatile("" : "+v"(tid_));
    const int tid = tid_, wid = __builtin_amdgcn_readfirstlane(tid >> 6), lane = tid & 63, wr = wid >> 2, wc = wid & 3, fr = lane & 15, fq = lane >> 4;
    const int nt = K / BK;
    unsigned voffA[2], voffB[2];
#pragma unroll
    for (int i = 0; i < 2; ++i) { int R, C; stage_rc(tid * 16 + i * 8192, R, C); const int Rb = Epi::PERM ? ((R & ~31) + perm32(R & 31)) : R;
        voffA[i] = (unsigned)(R * lda + C) * 2u; voffB[i] = (unsigned)(Rb * ldb + C) * 2u; }
    const size_t kstep = (size_t)(BK * 2);
    const size_t hstepA = (size_t)HALF * lda * 2, hstepB = (size_t)HALF * ldb * 2;
    const unsigned ldsw = (unsigned)wid * 1024u;
    const int aoff = lds_byte(wr * 64 + fr, fq * 8), boff = lds_byte(wc * 32 + fr, fq * 8);
#define PG8_SA(b, h) (((b) * 2 + (h)) * HTB)
#define PG8_SB(b, h) ((4 + (b) * 2 + (h)) * HTB)
#define PG8_STAGE(bufoff, gbase, voff) do { _Pragma("unroll") for (int _i = 0; _i < 2; ++_i) \
        __builtin_amdgcn_global_load_lds((const unsigned*)((const char*)(gbase) + (voff)[_i]), (LAS unsigned*)(lds + (bufoff) + ldsw + _i * 8192), 16, 0, 0); } while (0)
#define PG8_LDA(dst, b, h) do { _Pragma("unroll") for (int m = 0; m < 4; ++m) _Pragma("unroll") for (int k = 0; k < 2; ++k) dst[m][k] = *(const LAS bf16x8*)(lds + PG8_SA(b, h) + aoff + m * 2048 + k * 1024); } while (0)
#define PG8_LDB(dst, b, h) do { _Pragma("unroll") for (int n = 0; n < 2; ++n) _Pragma("unroll") for (int k = 0; k < 2; ++k) dst[n][k] = *(const LAS bf16x8*)(lds + PG8_SB(b, h) + boff + n * 2048 + k * 1024); } while (0)
#define PG8_MMA(ai, bj, At, Bt) do { __builtin_amdgcn_s_setprio(1); _Pragma("unroll") for (int m = 0; m < 4; ++m) _Pragma("unroll") for (int n = 0; n < 2; ++n) _Pragma("unroll") for (int k = 0; k < 2; ++k) \
        acc[ai][bj][m][n] = __builtin_amdgcn_mfma_f32_16x16x32_bf16(Bt[n][k], At[m][k], acc[ai][bj][m][n], 0, 0, 0); __builtin_amdgcn_s_setprio(0); } while (0)
#define PG8_WAIT_V(n) asm volatile("s_waitcnt vmcnt(" #n ")" ::: "memory")
#define PG8_WAIT_L(n) asm volatile("s_waitcnt lgkmcnt(" #n ")" ::: "memory")
#define PG8_BAR __builtin_amdgcn_s_barrier()
#define PG8_SCHED __builtin_amdgcn_sched_barrier(0)
    Unit cur, nxt; int ui = 0;
    if (!S.next(0, cur)) return;
    f32x4 acc[2][2][4][2];
#pragma unroll
    for (int a = 0; a < 2; ++a)
#pragma unroll
        for (int b = 0; b < 2; ++b)
#pragma unroll
            for (int m = 0; m < 4; ++m)
#pragma unroll
                for (int n = 0; n < 2; ++n) acc[a][b][m][n] = (f32x4){0.f, 0.f, 0.f, 0.f};
    bf16x8 At[4][2], B0[2][2], B1[2][2];
    const char* cA = cur.a; const char* cB = cur.b;
    PG8_STAGE(PG8_SB(0, 0), cB, voffB); PG8_STAGE(PG8_SB(0, 1), cB + hstepB, voffB); PG8_STAGE(PG8_SA(0, 0), cA, voffA); PG8_STAGE(PG8_SA(0, 1), cA + hstepA, voffA);
    if (wr == 1) PG8_BAR;
    PG8_WAIT_V(2); PG8_BAR;
    PG8_STAGE(PG8_SB(1, 0), cB + kstep, voffB); PG8_STAGE(PG8_SA(1, 0), cA + kstep, voffA); PG8_STAGE(PG8_SB(1, 1), cB + hstepB + kstep, voffB);
    PG8_WAIT_V(6); PG8_BAR;
    for (;;) {
        const bool has_next = S.next(ui + 1, nxt);
        const char* nA = has_next ? nxt.a : cA; const char* nB = has_next ? nxt.b : cB;
        for (int t = 0; t < nt; t += 2) {
            const bool last = (t == nt - 2);
            const char* a1 = cA + (size_t)(t + 1) * kstep;
            const char* a2 = last ? nA : cA + (size_t)(t + 2) * kstep; const char* b2 = last ? nB : cB + (size_t)(t + 2) * kstep;
            const char* a3 = a2 + kstep; const char* b3 = b2 + kstep;
            PG8_LDB(B0, 0, 0); PG8_LDB(B1, 0, 1); PG8_SCHED; PG8_LDA(At, 0, 0); PG8_STAGE(PG8_SA(1, 1), a1 + hstepA, voffA);
            PG8_WAIT_V(8); PG8_WAIT_L(0); PG8_BAR; PG8_MMA(0, 0, At, B0); PG8_MMA(0, 1, At, B1); PG8_BAR; PG8_SCHED;
            PG8_LDA(At, 0, 1); PG8_STAGE(PG8_SB(0, 0), b2, voffB); PG8_STAGE(PG8_SB(0, 1), b2 + hstepB, voffB); PG8_STAGE(PG8_SA(0, 0), a2, voffA);
            PG8_WAIT_V(8); PG8_WAIT_L(0); PG8_BAR; PG8_MMA(1, 0, At, B0); PG8_MMA(1, 1, At, B1); PG8_BAR; PG8_SCHED;
            PG8_LDB(B0, 1, 0); PG8_LDB(B1, 1, 1); PG8_SCHED; PG8_LDA(At, 1, 0); PG8_STAGE(PG8_SA(0, 1), a2 + hstepA, voffA);
            PG8_WAIT_V(8); PG8_WAIT_L(0); PG8_BAR; PG8_MMA(0, 0, At, B0); PG8_MMA(0, 1, At, B1); PG8_BAR; PG8_SCHED;
            PG8_LDA(At, 1, 1); PG8_STAGE(PG8_SB(1, 0), b3, voffB); PG8_STAGE(PG8_SB(1, 1), b3 + hstepB, voffB); PG8_STAGE(PG8_SA(1, 0), a3, voffA);
            PG8_WAIT_V(8); PG8_WAIT_L(0); PG8_BAR; PG8_MMA(1, 0, At, B0); PG8_MMA(1, 1, At, B1); PG8_BAR; PG8_SCHED;
        }
        if constexpr (ALIGN_EPI) { if (wr == 0) PG8_BAR; }
        E(acc, cur, wr, wc, fr, fq);
        if (!has_next) break;
#pragma unroll
        for (int a = 0; a < 2; ++a)
#pragma unroll
            for (int b = 0; b < 2; ++b)
#pragma unroll
                for (int m = 0; m < 4; ++m)
#pragma unroll
                    for (int n = 0; n < 2; ++n) acc[a][b][m][n] = (f32x4){0.f, 0.f, 0.f, 0.f};
        cur = nxt; cA = nA; cB = nB; ++ui;
        if constexpr (ALIGN_EPI) { if (wr == 1) PG8_BAR; }
    }
    PG8_WAIT_V(0);
    if constexpr (!ALIGN_EPI) { if (wr == 0) PG8_BAR; }
    PG8_BAR;
#undef PG8_SA
#undef PG8_SB
#undef PG8_STAGE
#undef PG8_LDA
#undef PG8_LDB
#undef PG8_MMA
#undef PG8_WAIT_V
#undef PG8_WAIT_L
#undef PG8_BAR
#undef PG8_SCHED
}
}
namespace epi {
using pg8::Unit;
constexpr int BM = 256, HALF = 128;
__device__ __forceinline__ int cond_of_pm(int pm) { return pm < 32 ? 0 : 1 + ((pm - 32) >> 4); }

struct EpiWc {
    static constexpr bool PERM = true;
    bf16_t* B0; bf16_t* B1;
    __device__ __forceinline__ void operator()(const f32x4 (&acc)[2][2][4][2], const Unit& u, int wr, int wc, int fr, int fq) const {
        const int j = u.job >> 2, g = u.job & 3; bf16_t* base = (j ? B1 : B0) + (size_t)(g * 512 + u.pm * BM) * 1024;
        const int row0 = wr * 64 + fr, col0 = u.pn * BM + wc * 32 + 8 * fq;
#pragma unroll
        for (int ai = 0; ai < 2; ++ai)
#pragma unroll
            for (int m = 0; m < 4; ++m) { bf16_t* rowp = base + (size_t)(row0 + ai * HALF + m * 16) * 1024 + col0;
#pragma unroll
                for (int bj = 0; bj < 2; ++bj) { const f32x4 v0 = acc[ai][bj][m][0], v1 = acc[ai][bj][m][1];
                    u32x4 w; w.x = cvt_pk_bf16(v0[0], v0[1]); w.y = cvt_pk_bf16(v0[2], v0[3]); w.z = cvt_pk_bf16(v1[0], v1[1]); w.w = cvt_pk_bf16(v1[2], v1[3]);
                    *(u32x4*)(rowp + bj * HALF) = w; } }
    }
};

struct EpiPoolG1 {
    static constexpr bool PERM = true;
    bf16_t* U; bf16_t* S; const float* scale;
    __device__ __forceinline__ void operator()(const f32x4 (&acc)[2][2][4][2], const Unit& u, int wr, int wc, int fr, int fq) const {
        const int row0 = u.pm * BM + wr * 64 + fr; int colt = u.pn * BM; const bool isg = colt >= 2048; bf16_t* base = isg ? S : U; if (isg) colt -= 2048;
        const int col0 = colt + wc * 32 + 8 * fq;
        f32x4 sc[2][2];
#pragma unroll
        for (int bj = 0; bj < 2; ++bj)
#pragma unroll
            for (int n = 0; n < 2; ++n) sc[bj][n] = isg ? *(const f32x4*)(scale + col0 + bj * HALF + 4 * n) : (f32x4){1.f, 1.f, 1.f, 1.f};
#pragma unroll
        for (int ai = 0; ai < 2; ++ai)
#pragma unroll
            for (int m = 0; m < 4; ++m) { bf16_t* rowp = base + (size_t)(row0 + ai * HALF + m * 16) * 2048 + col0;
#pragma unroll
                for (int bj = 0; bj < 2; ++bj) { f32x4 v0 = acc[ai][bj][m][0], v1 = acc[ai][bj][m][1];
                    if (isg) {
#pragma unroll
                        for (int i = 0; i < 4; ++i) { v0[i] = silu_f(v0[i]) * sc[bj][0][i]; v1[i] = silu_f(v1[i]) * sc[bj][1][i]; } }
                    u32x4 w; w.x = cvt_pk_bf16(v0[0], v0[1]); w.y = cvt_pk_bf16(v0[2], v0[3]); w.z = cvt_pk_bf16(v1[0], v1[1]); w.w = cvt_pk_bf16(v1[2], v1[3]);
                    *(u32x4*)(rowp + bj * HALF) = w; } }
    }
};

struct EpiRes {
    static constexpr bool PERM = false;
    const float* Xp; const float* Xs;
    float* R; const float* gate;
    __device__ __forceinline__ void operator()(const f32x4 (&acc)[2][2][4][2], const Unit& u, int wr, int wc, int fr, int fq) const {
        const int row0 = u.pm * BM + wr * 64 + fr, col0 = u.pn * BM + wc * 32 + 4 * fq; const int cr = cond_of_pm(u.pm);
        const float* X = u.pm < 32 ? Xp : Xs;
        f32x4 gv[2][2];
#pragma unroll
        for (int bj = 0; bj < 2; ++bj)
#pragma unroll
            for (int n = 0; n < 2; ++n) gv[bj][n] = *(const f32x4*)(gate + cr * 3072 + col0 + bj * HALF + n * 16);
#pragma unroll
        for (int ai = 0; ai < 2; ++ai)
#pragma unroll
            for (int m = 0; m < 4; ++m) { const size_t off = (size_t)(row0 + ai * HALF + m * 16) * 1024 + col0;
#pragma unroll
                for (int bj = 0; bj < 2; ++bj)
#pragma unroll
                    for (int n = 0; n < 2; ++n) { const f32x4 xs = *(const f32x4*)(X + off + bj * HALF + n * 16);
                        *(f32x4*)(R + off + bj * HALF + n * 16) = ALPHA * xs + gv[bj][n] * acc[ai][bj][m][n]; }
                asm volatile("" ::: "memory"); }
    }
};

struct EpiSguG1 {
    static constexpr bool PERM = true;
    bf16_t* UG; bf16_t* VG; float* stats;
    __device__ __forceinline__ void operator()(const f32x4 (&acc)[2][2][4][2], const Unit& u, int wr, int wc, int fr, int fq) const {
        const int row0 = u.pm * BM + wr * 64 + fr;
        if (u.pn < 16) {
            const int col0 = u.pn * 128 + wc * 32 + 8 * fq;
#pragma unroll
            for (int ai = 0; ai < 2; ++ai)
#pragma unroll
                for (int m = 0; m < 4; ++m) { f32x4 v0 = acc[ai][0][m][0], v1 = acc[ai][0][m][1]; const f32x4 g0 = acc[ai][1][m][0], g1 = acc[ai][1][m][1];
#pragma unroll
                    for (int i = 0; i < 4; ++i) { v0[i] = gelu_f(v0[i]) * silu_f(g0[i]); v1[i] = gelu_f(v1[i]) * silu_f(g1[i]); }
                    u32x4 w; w.x = cvt_pk_bf16(v0[0], v0[1]); w.y = cvt_pk_bf16(v0[2], v0[3]); w.z = cvt_pk_bf16(v1[0], v1[1]); w.w = cvt_pk_bf16(v1[2], v1[3]);
                    *(u32x4*)(UG + (size_t)(row0 + ai * HALF + m * 16) * 2048 + col0) = w; }
        } else {
            const int pv = u.pn - 16, col0 = pv * BM + wc * 32 + 8 * fq;
#pragma unroll
            for (int ai = 0; ai < 2; ++ai)
#pragma unroll
                for (int m = 0; m < 4; ++m) { const size_t row = (size_t)(row0 + ai * HALF + m * 16); float s = 0.f, q = 0.f;
#pragma unroll
                    for (int bj = 0; bj < 2; ++bj) { f32x4 v0 = acc[ai][bj][m][0], v1 = acc[ai][bj][m][1];
#pragma unroll
                        for (int i = 0; i < 4; ++i) { v0[i] = gelu_f(v0[i]); v1[i] = gelu_f(v1[i]); s += v0[i] + v1[i]; q += v0[i] * v0[i] + v1[i] * v1[i]; }
                        u32x4 w; w.x = cvt_pk_bf16(v0[0], v0[1]); w.y = cvt_pk_bf16(v0[2], v0[3]); w.z = cvt_pk_bf16(v1[0], v1[1]); w.w = cvt_pk_bf16(v1[2], v1[3]);
                        *(u32x4*)(VG + row * 2048 + col0 + bj * HALF) = w; }
                    s += __shfl_xor(s, 16); s += __shfl_xor(s, 32); q += __shfl_xor(q, 16); q += __shfl_xor(q, 32);
                    if (fq == 0) *(f32x2*)(stats + (row * 32 + pv * 4 + wc) * 2) = (f32x2){s, q}; }
        }
    }
};

struct EpiAttnG1 {
    static constexpr bool PERM = true;
    bf16_t* QKVS; float* ctx;
    __device__ __forceinline__ void operator()(const f32x4 (&acc)[2][2][4][2], const Unit& u, int wr, int wc, int fr, int fq) const {
        const int t = u.pn >> 2, row0 = u.pm * BM + wr * 64 + fr, col0 = (u.pn & 3) * BM + wc * 32 + 8 * fq;
        bf16_t* base = QKVS + (size_t)t * T * 1024; const bool f32o = (t == 1 || t == 2) && u.pm < 32; float* cb = ctx + (size_t)(t - 1) * TP * 1024;
#pragma unroll
        for (int ai = 0; ai < 2; ++ai)
#pragma unroll
            for (int m = 0; m < 4; ++m) { const size_t off = (size_t)(row0 + ai * HALF + m * 16) * 1024 + col0;
#pragma unroll
                for (int bj = 0; bj < 2; ++bj) { f32x4 v0 = acc[ai][bj][m][0], v1 = acc[ai][bj][m][1];
                    if (t == 0) { v0 = v0 * 0.125f; v1 = v1 * 0.125f; }
                    if (t == 3) {
#pragma unroll
                        for (int i = 0; i < 4; ++i) { v0[i] = silu_f(v0[i]); v1[i] = silu_f(v1[i]); } }
                    if (f32o) { *(f32x4*)(cb + off + bj * HALF) = v0; *(f32x4*)(cb + off + bj * HALF + 4) = v1; }
                    u32x4 w; w.x = cvt_pk_bf16(v0[0], v0[1]); w.y = cvt_pk_bf16(v0[2], v0[3]); w.z = cvt_pk_bf16(v1[0], v1[1]); w.w = cvt_pk_bf16(v1[2], v1[3]);
                    *(u32x4*)(base + off + bj * HALF) = w; } }
    }
};
}
typedef GAS unsigned gu32;
#define RLX_AGENT __ATOMIC_RELAXED, __HIP_MEMORY_SCOPE_AGENT

constexpr size_t WS_CTL = 0, CTL_ZERO_BYTES = 65536;
constexpr size_t WS_MOD = 65536;
constexpr size_t WS_HB = 1 * MiB;
constexpr size_t WS_ACT = 49 * MiB, ACT_SLOT = 48 * MiB;
constexpr size_t WS_TAIL = 241 * MiB;
constexpr size_t WS_BP1 = WS_TAIL, WS_WO1 = WS_TAIL + 8 * MiB, WS_BNA = WS_TAIL + 12 * MiB, WS_WONA = WS_TAIL + 20 * MiB, WS_END = WS_TAIL + 22 * MiB;
constexpr size_t OUT_CTX = (size_t)T * D * 4;
constexpr size_t CX_BP0 = 0, CX_WO0 = 8 * MiB, CX_BSGU = 12 * MiB, CX_WOSGU = 24 * MiB, CX_WXB = 28 * MiB, CX_GT = 36 * MiB, CX_STATS = 40 * MiB, CX_RS = 46 * MiB;
constexpr int CW_BAR = 1024;

constexpr int RING_BYTES = 131072, LDSCTL_OFF = RING_BYTES, MISC_OFF = LDSCTL_OFF + 320, LDS_BYTES = 147456;

#define XB_TMO      128
#define XB_XCNT(j)  (256  + 64 * (j))
#define XB_XSUB(j)  (1280 + 64 * (j))
#define XB_XGEN(j)  (2304 + 64 * (j))
#define XB_TOP      3328
#define XB_TOPGEN   3392
#define XCD_BAR_WORDS 3456
#define XB_SPIN_CAP (1u << 22)
__device__ __forceinline__ unsigned xb_ld(unsigned* p)              { return __hip_atomic_load(p, __ATOMIC_RELAXED, __HIP_MEMORY_SCOPE_AGENT); }
__device__ __forceinline__ unsigned xb_add(unsigned* p, unsigned v) { return __hip_atomic_fetch_add(p, v, __ATOMIC_RELAXED, __HIP_MEMORY_SCOPE_AGENT); }
__device__ __forceinline__ unsigned xb_xcc_id() { return (unsigned)__builtin_amdgcn_s_getreg((3 << 11) | 20) & 0xFu; }
#define XB_SPIN(cond, bar) do { unsigned _sp = 0; while (cond) { __builtin_amdgcn_s_sleep(1); \
    if ((++_sp & 255u) == 0u) { if (xb_ld(&(bar)[XB_TMO])) break; if (_sp > XB_SPIN_CAP) { atomicAdd(&(bar)[XB_TMO], 1u); break; } } } } while (0)
struct XcdBarrier { unsigned* bar; unsigned x; volatile LAS unsigned* st; };
__device__ __forceinline__ XcdBarrier xcd_barrier_post(unsigned* bar, volatile LAS unsigned* st) {
    XcdBarrier b; b.bar = bar; b.x = xb_xcc_id(); b.st = st;
    if (threadIdx.x == 0) (void)xb_add(&bar[XB_XCNT(b.x)], 1u);
    return b;
}
__device__ __forceinline__ void xcd_barrier_complete(unsigned* bar, unsigned x, unsigned& nloc, unsigned& nx) {
    const unsigned G = gridDim.x * gridDim.y * gridDim.z;
    unsigned sum, cnt, mine, sp = 0u;
    for (;;) {
        sum = 0u; cnt = 0u; mine = 0u;
#pragma unroll
        for (unsigned j = 0; j < 16; ++j) { const unsigned c = xb_ld(&bar[XB_XCNT(j)]); sum += c; cnt += (c > 0u) ? 1u : 0u; mine = (j == x) ? c : mine; }
        if (sum == G) break;
        __builtin_amdgcn_s_sleep(1);
        if ((++sp & 255u) == 0u) { if (xb_ld(&bar[XB_TMO])) break; if (sp > XB_SPIN_CAP) { atomicAdd(&bar[XB_TMO], 1u); break; } }
    }
    nloc = mine > 0u ? mine : 1u; nx = cnt > 0u ? cnt : 1u;
}
__device__ __forceinline__ void xcd_barrier(const XcdBarrier& b) {
    asm volatile("s_waitcnt vmcnt(0)" ::: "memory");
    __syncthreads();
    if (threadIdx.x == 0) {
        unsigned* bar = b.bar;
        __builtin_amdgcn_s_waitcnt(0);
        unsigned nloc = b.st[0], nx = b.st[1];
        if (nloc == 0u) { xcd_barrier_complete(bar, b.x, nloc, nx); b.st[0] = nloc; b.st[1] = nx; }
        const unsigned old = xb_add(&bar[XB_XSUB(b.x)], 1u);
        const unsigned gen = old / nloc;
        if (old + 1u == (gen + 1u) * nloc) {
            __builtin_amdgcn_fence(__ATOMIC_RELEASE, "agent");
            asm volatile("s_waitcnt vmcnt(0)" ::: "memory");
            const unsigned og = xb_add(&bar[XB_TOP], 1u);
            const unsigned tg = og / nx;
            if (og + 1u == (tg + 1u) * nx) xb_add(&bar[XB_TOPGEN], 1u);
            else XB_SPIN(xb_ld(&bar[XB_TOPGEN]) == tg, bar);
            __builtin_amdgcn_fence(__ATOMIC_ACQUIRE, "agent");
            xb_add(&bar[XB_XGEN(b.x)], 1u);
            asm volatile("s_waitcnt vmcnt(0)" ::: "memory");
        } else {
            XB_SPIN(xb_ld(&bar[XB_XGEN(b.x)]) == gen, bar);
            __builtin_amdgcn_fence(__ATOMIC_ACQUIRE, "agent");
            asm volatile("s_waitcnt vmcnt(0)" ::: "memory");
        }
    }
    __syncthreads();
}

struct Frame {
    LAS unsigned char* lds;
    int tid, lane, wave, vcu, G;
    const float* const* in;
    float* out; unsigned char* ws; unsigned char* cx;
    float* mod;
};

__device__ __forceinline__ void relaunder(Frame& F) { int t = threadIdx.x; asm volatile("" : "+v"(t)); F.tid = t; F.lane = t & 63; F.wave = __builtin_amdgcn_readfirstlane(t >> 6); }
__device__ __forceinline__ float wave_sum(float v) {
#pragma unroll
    for (int o = 1; o < 64; o <<= 1) v += __shfl_xor(v, o);
    return v;
}
__device__ __forceinline__ int cond_of_row(int row) { return row < TP ? 0 : 1 + ((row - TP) >> 12); }

__device__ __forceinline__ void transpose_item(const float* W, int ldw, bf16_t* WTrow0, int ldd, int k0, int n0, LAS float* scr, int lane) {
#pragma unroll 8
    for (int i = 0; i < 32; ++i) { const int kk = 2 * i + (lane >> 5); scr[kk * 33 + (lane & 31)] = W[(size_t)(k0 + kk) * ldw + n0 + (lane & 31)]; }
    LDS_WAIT(); asm volatile("" ::: "memory");
    const int c = lane & 7;
#pragma unroll
    for (int j = 0; j < 4; ++j) { const int n = (lane >> 3) + 8 * j; const LAS float* s = scr + (8 * c) * 33 + n;
        u32x4 o; o.x = cvt_pk_bf16(s[0 * 33], s[1 * 33]); o.y = cvt_pk_bf16(s[2 * 33], s[3 * 33]); o.z = cvt_pk_bf16(s[4 * 33], s[5 * 33]); o.w = cvt_pk_bf16(s[6 * 33], s[7 * 33]);
        *(GAS u32x4*)(WTrow0 + (size_t)n * ldd + k0 + 8 * c) = o; }
    LDS_WAIT(); asm volatile("" ::: "memory");
}
__device__ __forceinline__ int sgu_row_of(int n) { if (n < 2048) return (n >> 7) * 256 + (n & 127); if (n < 4096) return 4096 + (n - 2048); const int e = n - 4096; return (e >> 7) * 256 + 128 + (e & 127); }

__device__ __forceinline__ void phase_prep(Frame& F) {
    const float* c = F.in[2]; const float* c_ctx = F.in[5]; const float* w_mod = F.in[6]; const float* b_mod = F.in[7];
    {
        LAS float* sc = (LAS float*)F.lds;
        LAS float* red = (LAS float*)(F.lds + 20480);
        for (int idx = F.tid; idx < 5 * 1024; idx += 512) { const int cr = idx >> 10, k = idx & 1023; const float v = cr == 0 ? c_ctx[k] : c[(cr - 1) * 1024 + k]; sc[idx] = v / (1.f + expf(-v)); }
        __syncthreads();
        for (int task = F.vcu; task < 4 * 48; task += F.G) {
            const int i = task / 48, cb = task % 48, col = cb * 64 + F.lane;
            const float* W = w_mod + (size_t)i * 1024 * 3072 + col;
            float a0 = 0.f, a1 = 0.f, a2 = 0.f, a3 = 0.f, a4 = 0.f;
#pragma unroll 16
            for (int kk = 0; kk < 128; ++kk) { const int k = F.wave * 128 + kk; const float w = W[(size_t)k * 3072];
                a0 += sc[k] * w; a1 += sc[1024 + k] * w; a2 += sc[2048 + k] * w; a3 += sc[3072 + k] * w; a4 += sc[4096 + k] * w; }
            red[(F.wave * 5 + 0) * 64 + F.lane] = a0; red[(F.wave * 5 + 1) * 64 + F.lane] = a1; red[(F.wave * 5 + 2) * 64 + F.lane] = a2; red[(F.wave * 5 + 3) * 64 + F.lane] = a3; red[(F.wave * 5 + 4) * 64 + F.lane] = a4;
            __syncthreads();
            if (F.tid < 320) { const int cr = F.tid >> 6, l = F.tid & 63; float s = 0.f;
#pragma unroll
                for (int w = 0; w < 8; ++w) s += red[(w * 5 + cr) * 64 + l];
                F.mod[((size_t)i * 5 + cr) * 3072 + cb * 64 + l] = s + b_mod[i * 3072 + cb * 64 + l]; }
            __syncthreads();
        }
        __syncthreads();
    }
    LAS float* scr = (LAS float*)(F.lds + F.wave * 16384);
    const int gw = F.vcu * NWAVES + F.wave, NGW = F.G * NWAVES;
    const float* pool_w_in = F.in[10]; const float* pool_w_grp = F.in[11]; const float* pool_w_out = F.in[13]; const float* sgu_w_in = F.in[14]; const float* sgu_w_s = F.in[17]; const float* sgu_w_out = F.in[19];
    const float* na_w_in = F.in[20]; const float* na_w_out = F.in[22];
    bf16_t* BP0 = (bf16_t*)(F.cx + CX_BP0); bf16_t* BP1 = (bf16_t*)(F.ws + WS_BP1); bf16_t* WO0 = (bf16_t*)(F.cx + CX_WO0); bf16_t* WO1 = (bf16_t*)(F.ws + WS_WO1);
    bf16_t* BSGU = (bf16_t*)(F.cx + CX_BSGU); bf16_t* WOSGU = (bf16_t*)(F.cx + CX_WOSGU); bf16_t* BNA = (bf16_t*)(F.ws + WS_BNA); bf16_t* WONA = (bf16_t*)(F.ws + WS_WONA);
    bf16_t* WXB = (bf16_t*)(F.cx + CX_WXB); bf16_t* GT = (bf16_t*)(F.cx + CX_GT);
    constexpr int I_PG = 16 * 64, I_PO = 32 * 32, I_SI = 16 * 192, I_SO = 32 * 32, I_NI = 16 * 128, I_NO = 16 * 32, I_G = 8 * 16;
    constexpr int NITEMS = 2 * I_PG + 2 * I_PO + I_SI + I_SO + I_NI + I_NO + 8 * I_G;
    for (int it = gw; it < NITEMS; it += NGW) {
        int r = it;
        if (r < 2 * I_PG) { const int j = r / I_PG; r %= I_PG; const int kb = r / 64, nb = r % 64;
            transpose_item(pool_w_in + (size_t)j * 1024 * 4096 + 2048, 4096, (j ? BP1 : BP0) + (size_t)(2048 + nb * 32) * 1024, 1024, kb * 64, nb * 32, scr, F.lane); continue; } r -= 2 * I_PG;
        if (r < 2 * I_PO) { const int j = r / I_PO; r %= I_PO; const int kb = r / 32, nb = r % 32;
            transpose_item(pool_w_out + (size_t)j * 2048 * 1024, 1024, (j ? WO1 : WO0) + (size_t)(nb * 32) * 2048, 2048, kb * 64, nb * 32, scr, F.lane); continue; } r -= 2 * I_PO;
        if (r < I_SI) { const int kb = r / 192, nb = r % 192;
            transpose_item(sgu_w_in, 6144, BSGU + (size_t)sgu_row_of(nb * 32) * 1024, 1024, kb * 64, nb * 32, scr, F.lane); continue; } r -= I_SI;
        if (r < I_SO) { const int kb = r / 32, nb = r % 32;
            transpose_item(sgu_w_out, 1024, WOSGU + (size_t)(nb * 32) * 2048, 2048, kb * 64, nb * 32, scr, F.lane); continue; } r -= I_SO;
        if (r < I_NI) { const int kb = r / 128, nb = r % 128;
            transpose_item(na_w_in, 4096, BNA + (size_t)(nb * 32) * 1024, 1024, kb * 64, nb * 32, scr, F.lane); continue; } r -= I_NI;
        if (r < I_NO) { const int kb = r / 32, nb = r % 32;
            transpose_item(na_w_out, 1024, WONA + (size_t)(nb * 32) * 1024, 1024, kb * 64, nb * 32, scr, F.lane); continue; } r -= I_NO;
        { const int q = r / I_G; r %= I_G; const int kb = r / 16, nb = r % 16;
            transpose_item(pool_w_grp + (size_t)q * 512 * 512, 512, GT + (size_t)q * 512 * 512 + (size_t)(nb * 32) * 512, 512, kb * 64, nb * 32, scr, F.lane); }
    }
    for (int it = gw; it < 2048; it += NGW) { const int j = it >> 10, k = it & 1023; const float* src = pool_w_in + ((size_t)j * 1024 + k) * 4096; bf16_t* dst = WXB + ((size_t)j * 1024 + k) * 2048;
#pragma unroll
        for (int jj = 0; jj < 8; ++jj) { const f32x4 v = *(const f32x4*)(src + 4 * F.lane + 256 * jj); u32x2 o; o.x = cvt_pk_bf16(v[0], v[1]); o.y = cvt_pk_bf16(v[2], v[3]); *(u32x2*)(dst + 4 * F.lane + 256 * jj) = o; } }
    { float* RS = (float*)(F.cx + CX_RS);
      for (int it = gw; it < 1024; it += NGW) { const float* src = sgu_w_s + (size_t)it * 128; const float s = wave_sum(src[F.lane] + src[64 + F.lane]); if (F.lane == 0) RS[it] = s; } }
}

__device__ __forceinline__ void modulate_store(const f32x4 (&v)[4], const float* modrow, bf16_t* hrow, int lane) {
#pragma unroll
    for (int j = 0; j < 4; ++j) { const int col = 4 * lane + 256 * j; const f32x4 sh = *(const f32x4*)(modrow + col), sc = *(const f32x4*)(modrow + 1024 + col);
        const f32x4 h = v[j] * (1.f + sc) + sh; u32x2 o; o.x = cvt_pk_bf16(h[0], h[1]); o.y = cvt_pk_bf16(h[2], h[3]); *(u32x2*)(hrow + col) = o; }
}
__device__ __forceinline__ void phase_hb0(Frame& F, int wg0) {
    if (F.vcu < wg0) return;
    const int gw = (F.vcu - wg0) * NWAVES + F.wave, NGW = (F.G - wg0) * NWAVES; bf16_t* HB = (bf16_t*)(F.ws + WS_HB);
    for (int row = gw; row < T; row += NGW) { const float* xr = row < TP ? F.in[0] + (size_t)row * D : F.in[1] + (size_t)(row - TP) * D;
        f32x4 v[4];
#pragma unroll
        for (int j = 0; j < 4; ++j) v[j] = *(const f32x4*)(xr + 4 * F.lane + 256 * j);
        modulate_store(v, F.mod + (size_t)cond_of_row(row) * 3072, HB + (size_t)row * D, F.lane); }
}
__device__ __forceinline__ void phase_ln(Frame& F, int layer, int nxt_layer) {
    const int gw = F.vcu * NWAVES + F.wave, NGW = F.G * NWAVES; bf16_t* HB = (bf16_t*)(F.ws + WS_HB);
    const float* g = F.in[8] + layer * D; const float* b = F.in[9] + layer * D;
    for (int row = gw; row < T; row += NGW) { float* xr = F.out + (size_t)row * D;
        f32x4 v[4]; float s = 0.f;
#pragma unroll
        for (int j = 0; j < 4; ++j) { v[j] = *(const f32x4*)(xr + 4 * F.lane + 256 * j); s += (v[j][0] + v[j][1]) + (v[j][2] + v[j][3]); }
        const float mean = wave_sum(s) * (1.f / D); float q = 0.f;
#pragma unroll
        for (int j = 0; j < 4; ++j) { v[j] = v[j] - mean; q += (v[j][0] * v[j][0] + v[j][1] * v[j][1]) + (v[j][2] * v[j][2] + v[j][3] * v[j][3]); }
        const float rstd = 1.f / sqrtf(wave_sum(q) * (1.f / D) + LN_EPS);
#pragma unroll
        for (int j = 0; j < 4; ++j) { const int col = 4 * F.lane + 256 * j; v[j] = v[j] * rstd * *(const f32x4*)(g + col) + *(const f32x4*)(b + col); *(f32x4*)(xr + col) = v[j]; }
        if (nxt_layer >= 0) modulate_store(v, F.mod + ((size_t)nxt_layer * 5 + cond_of_row(row)) * 3072, HB + (size_t)row * D, F.lane); }
}

__device__ __forceinline__ void unpack8(const u32x4 w, float (&f)[8]) { f[0] = bflo(w.x); f[1] = bfhi(w.x); f[2] = bflo(w.y); f[3] = bfhi(w.y); f[4] = bflo(w.z); f[5] = bfhi(w.z); f[6] = bflo(w.w); f[7] = bfhi(w.w); }
__device__ __forceinline__ void phase_pool(Frame& F) {
    const int gw = F.vcu * NWAVES + F.wave, NGW = F.G * NWAVES;
    const bf16_t* U = (const bf16_t*)(F.ws + WS_ACT); bf16_t* S = (bf16_t*)(F.ws + WS_ACT + 2 * ACT_SLOT);
    for (int it = gw; it < (T / 32) * 4; it += NGW) {
        const int g = it & 3, t0 = (it >> 2) * 32, hw = 1 << g;
        const int L = t0 < TP ? 256 : 4096, s0 = t0 < TP ? (t0 & ~255) : TP + ((t0 - TP) & ~4095), s1 = s0 + L;
        const bf16_t* Uc = U + g * 512 + F.lane * 8; bf16_t* Sc = S + g * 512 + F.lane * 8;
        float sum[8], f[8];
#pragma unroll
        for (int i = 0; i < 8; ++i) sum[i] = 0.f;
        for (int r = t0 - hw; r < t0 + hw; ++r) if (r >= s0 && r < s1) { unpack8(*(const u32x4*)(Uc + (size_t)r * 2048), f);
#pragma unroll
            for (int i = 0; i < 8; ++i) sum[i] += f[i]; }
        for (int t = t0; t < t0 + 32; ++t) {
            const int lo = (t - hw) > s0 ? (t - hw) : s0, hi = (t + hw - 1) < (s1 - 1) ? (t + hw - 1) : (s1 - 1); const float inv = 1.f / (float)(hi - lo + 1);
            float ut[8], st[8]; unpack8(*(const u32x4*)(Uc + (size_t)t * 2048), ut); unpack8(*(const u32x4*)(Sc + (size_t)t * 2048), st);
            float y[8];
#pragma unroll
            for (int i = 0; i < 8; ++i) y[i] = (sum[i] * inv - ut[i]) * st[i];
            u32x4 o; o.x = cvt_pk_bf16(y[0], y[1]); o.y = cvt_pk_bf16(y[2], y[3]); o.z = cvt_pk_bf16(y[4], y[5]); o.w = cvt_pk_bf16(y[6], y[7]);
            *(u32x4*)(Sc + (size_t)t * 2048) = o;
            if (t - hw >= s0) { unpack8(*(const u32x4*)(Uc + (size_t)(t - hw) * 2048), f);
#pragma unroll
                for (int i = 0; i < 8; ++i) sum[i] -= f[i]; }
            if (t + hw < s1) { unpack8(*(const u32x4*)(Uc + (size_t)(t + hw) * 2048), f);
#pragma unroll
                for (int i = 0; i < 8; ++i) sum[i] += f[i]; }
        }
    }
}

__device__ __forceinline__ void phase_sg(Frame& F) {
    bf16_t* UG = (bf16_t*)(F.ws + WS_ACT); const bf16_t* VG = (const bf16_t*)(F.ws + WS_ACT + 2 * ACT_SLOT);
    const float* stats = (const float*)(F.cx + CX_STATS); const float* RS = (const float*)(F.cx + CX_RS);
    const float* w_s = F.in[17]; const float* b_s = F.in[18]; const float* lg = F.in[15]; const float* lb = F.in[16];
    LAS bf16_t* At = (LAS bf16_t*)F.lds;
    LAS bf16_t* Bt = (LAS bf16_t*)(F.lds + 36864);
    LAS float* mu = (LAS float*)(F.lds + 104448); LAS float* rs = (LAS float*)(F.lds + 104960);
    const int fr = F.lane & 15, fq = F.lane >> 4, w = F.wave;
    for (int un = F.vcu; un < 192 * 8; un += F.G) {
        const int chunk = un >> 3, h = un & 7; const size_t row0 = (size_t)chunk * 128;
        if (F.tid < 128) { const float* sp = stats + (row0 + F.tid) * 64; float s = 0.f, q = 0.f;
#pragma unroll
            for (int i = 0; i < 16; ++i) { const f32x4 v = *(const f32x4*)(sp + 4 * i); s += v[0] + v[2]; q += v[1] + v[3]; }
            const float mean = s * (1.f / 2048.f), var = q * (1.f / 2048.f) - mean * mean; mu[F.tid] = mean; rs[F.tid] = 1.f / sqrtf(var + LN_EPS); }
        __syncthreads();
#pragma unroll
        for (int k = 0; k < 8; ++k) { const int idx = F.tid * 4 + 2048 * k, p = idx >> 7, q = idx & 127; const f32x4 wv = *(const f32x4*)(w_s + ((size_t)h * 128 + p) * 128 + q);
            u32x2 o; o.x = cvt_pk_bf16(wv[0] * rs[q], wv[1] * rs[q + 1]); o.y = cvt_pk_bf16(wv[2] * rs[q + 2], wv[3] * rs[q + 3]); *(LAS u32x2*)(At + p * 136 + q) = o; }
#pragma unroll
        for (int k = 0; k < 8; ++k) { const int idx = F.tid + 512 * k, q = idx >> 5, c8 = idx & 31; float f[8]; unpack8(*(const u32x4*)(VG + (row0 + q) * 2048 + h * 256 + c8 * 8), f); const float m = mu[q];
            u32x4 o; o.x = cvt_pk_bf16(f[0] - m, f[1] - m); o.y = cvt_pk_bf16(f[2] - m, f[3] - m); o.z = cvt_pk_bf16(f[4] - m, f[5] - m); o.w = cvt_pk_bf16(f[6] - m, f[7] - m);
            *(LAS u32x4*)(Bt + q * 264 + c8 * 8) = o; }
        __syncthreads();
        f32x4 acc[8][2];
#pragma unroll
        for (int m = 0; m < 8; ++m) { acc[m][0] = (f32x4){0.f, 0.f, 0.f, 0.f}; acc[m][1] = (f32x4){0.f, 0.f, 0.f, 0.f}; }
#pragma unroll
        for (int ks = 0; ks < 4; ++ks) {
            bf16x8 bfr[2];
#pragma unroll
            for (int n = 0; n < 2; ++n) { const LAS bf16_t* bp = Bt + (ks * 32 + 8 * fq) * 264 + 32 * w + n * 16 + fr;
#pragma unroll
                for (int j = 0; j < 8; ++j) bfr[n][j] = (short)bp[j * 264]; }
#pragma unroll
            for (int m = 0; m < 8; ++m) { const bf16x8 af = *(const LAS bf16x8*)(At + (m * 16 + fr) * 136 + ks * 32 + 8 * fq);
                acc[m][0] = __builtin_amdgcn_mfma_f32_16x16x32_bf16(bfr[0], af, acc[m][0], 0, 0, 0);
                acc[m][1] = __builtin_amdgcn_mfma_f32_16x16x32_bf16(bfr[1], af, acc[m][1], 0, 0, 0); }
        }
#pragma unroll
        for (int m = 0; m < 8; ++m) { const int p = m * 16 + fr; const float rsum = RS[h * 128 + p], bs = b_s[h * 128 + p];
#pragma unroll
            for (int n = 0; n < 2; ++n) { const int e0 = h * 256 + 32 * w + n * 16 + 4 * fq; const f32x4 g4 = *(const f32x4*)(lg + e0), b4 = *(const f32x4*)(lb + e0);
                bf16_t* yp = UG + (row0 + p) * 2048 + e0; const u32x2 ug = *(const u32x2*)yp;
                const f32x4 vp = g4 * acc[m][n] + b4 * rsum + bs;
                u32x2 o; o.x = cvt_pk_bf16(bflo(ug.x) * vp[0], bfhi(ug.x) * vp[1]); o.y = cvt_pk_bf16(bflo(ug.y) * vp[2], bfhi(ug.y) * vp[3]); *(u32x2*)yp = o; } }
        __syncthreads();
    }
}
namespace att {
constexpr int L_K = 0, L_V = 16384, L_RPB = 32768, L_WS = 34816, L_OST = 36864;
__device__ __forceinline__ int crow(int r, int hi) { return (r & 3) + 8 * (r >> 2) + 4 * hi; }
typedef short v4i16_t __attribute__((ext_vector_type(4)));
__device__ __forceinline__ s16x4 vtr(const LAS unsigned char* p) { return __builtin_bit_cast(s16x4, __builtin_amdgcn_ds_read_tr16_b64_v4i16((LAS v4i16_t*)p)); }

template <bool SAMPLE>
__device__ __forceinline__ void attn_unit(Frame& F, int b, int h, int R) {
    const int tid = F.tid, lane = F.lane, w = F.wave, r32 = lane & 31, hi = lane >> 5;
    bf16_t* Qb = (bf16_t*)(F.ws + WS_ACT); const bf16_t* Kb = (const bf16_t*)(F.ws + WS_ACT + ACT_SLOT); const bf16_t* Vb = (const bf16_t*)(F.ws + WS_ACT + 2 * ACT_SLOT); const bf16_t* Sg = (const bf16_t*)(F.ws + WS_ACT + 3 * ACT_SLOT);
    const float* cache_k = F.in[3]; const float* cache_v = F.in[4];
    LAS unsigned char* lds = F.lds;
    LAS float* rpbL = (LAS float*)(lds + L_RPB); LAS float* wsf = (LAS float*)(lds + L_WS) + w * 64;
    int qrow0, r = 0, cq = 0, r0w = 0, lo = 0, nband = 0, NT, kbase0;
    if (SAMPLE) { r = 4 * R + (w >> 1); cq = 32 * (w & 1) + r32; qrow0 = TP + b * 4096 + r * 64 + 32 * (w & 1);
        r0w = r - 4; r0w = r0w < 0 ? 0 : (r0w > 56 ? 56 : r0w);
        lo = 4 * R - 4; lo = lo < 0 ? 0 : (lo > 56 ? 56 : lo); int hi_r = 4 * R - 1; hi_r = hi_r < 0 ? 0 : (hi_r > 56 ? 56 : hi_r); nband = hi_r + 8 - lo; NT = nband + 8; kbase0 = TP + b * 4096; }
    else { qrow0 = b * 256 + 32 * w; NT = 4; kbase0 = b * 256; }
    if (SAMPLE) { const float* rp = F.in[21] + (size_t)h * 15 * 31; for (int i = tid; i < 15 * 32; i += 512) { const int dr = i >> 5, dc = i & 31; rpbL[i] = dc < 31 ? rp[dr * 31 + dc] * LOG2E : 0.f; } }
    bf16x8 qf[4];
#pragma unroll
    for (int st = 0; st < 4; ++st) qf[st] = *(const bf16x8*)(Qb + (size_t)(qrow0 + r32) * 1024 + h * 64 + st * 16 + hi * 8);
    const int skey = tid >> 3, sc8 = tid & 7;
    u32x4 kreg, vreg;
#define ATT_LOAD_TILE(ti_) do { const int ti__ = (ti_); \
        if (SAMPLE && ti__ >= nband) { const size_t off = (((size_t)b * 512 + (ti__ - nband) * 64 + skey) * 16 + h) * 64 + sc8 * 8; \
            const f32x4 k0 = *(const f32x4*)(cache_k + off), k1 = *(const f32x4*)(cache_k + off + 4), v0 = *(const f32x4*)(cache_v + off), v1 = *(const f32x4*)(cache_v + off + 4); \
            kreg.x = cvt_pk_bf16(k0[0], k0[1]); kreg.y = cvt_pk_bf16(k0[2], k0[3]); kreg.z = cvt_pk_bf16(k1[0], k1[1]); kreg.w = cvt_pk_bf16(k1[2], k1[3]); \
            vreg.x = cvt_pk_bf16(v0[0], v0[1]); vreg.y = cvt_pk_bf16(v0[2], v0[3]); vreg.z = cvt_pk_bf16(v1[0], v1[1]); vreg.w = cvt_pk_bf16(v1[2], v1[3]); \
        } else { const size_t off = (size_t)(kbase0 + (SAMPLE ? (lo + ti__) * 64 : ti__ * 64) + skey) * 1024 + h * 64 + sc8 * 8; \
            kreg = *(const u32x4*)(Kb + off); vreg = *(const u32x4*)(Vb + off); } } while (0)
#define ATT_STORE_TILE(slot_) do { \
        *(LAS u32x4*)(lds + L_K + (slot_) * 8192 + skey * 128 + ((sc8 ^ (skey & 7)) << 4)) = kreg; \
        *(LAS u32x4*)(lds + L_V + (slot_) * 8192 + skey * 128 + (sc8 << 4)) = vreg; } while (0)
    f32x16 o0, o1;
#pragma unroll
    for (int i = 0; i < 16; ++i) { o0[i] = 0.f; o1[i] = 0.f; }
    float m_run = -1e30f, l_run = 0.f;
    int c0 = cq - 8; c0 = c0 < 0 ? 0 : (c0 > 48 ? 48 : c0);
    const int vtb = (4 * hi + ((lane & 15) >> 2)) * 128 + (16 * ((lane >> 4) & 1) + 4 * (lane & 3)) * 2;
    ATT_LOAD_TILE(0);
    for (int ti = 0; ti < NT; ++ti) {
        const int slot = ti & 1;
        ATT_STORE_TILE(slot);
        if (ti + 1 < NT) ATT_LOAD_TILE(ti + 1);
        __syncthreads();
        const bool band = SAMPLE && ti < nband; const int rr = lo + ti;
        const bool part = !band || (rr >= r0w && rr < r0w + 8);
        if (part) {
            const LAS unsigned char* Ks = lds + L_K + slot * 8192; const LAS unsigned char* Vs = lds + L_V + slot * 8192;
            f32x16 p0, p1;
#pragma unroll
            for (int i = 0; i < 16; ++i) { p0[i] = 0.f; p1[i] = 0.f; }
#pragma unroll
            for (int st = 0; st < 4; ++st) { const int ch = ((2 * st + hi) ^ (r32 & 7)) << 4;
                const bf16x8 k0 = *(const LAS bf16x8*)(Ks + r32 * 128 + ch), k1 = *(const LAS bf16x8*)(Ks + (32 + r32) * 128 + ch);
                p0 = __builtin_amdgcn_mfma_f32_32x32x16_bf16(k0, qf[st], p0, 0, 0, 0); p1 = __builtin_amdgcn_mfma_f32_32x32x16_bf16(k1, qf[st], p1, 0, 0, 0); }
            float mx = -1e30f;
            if (band) { const int dr = rr - r + 7;
#pragma unroll
                for (int i = 0; i < 16; ++i) { const int ck0 = crow(i, hi), ck1 = 32 + ck0;
                    const bool v0 = ck0 >= c0 && ck0 < c0 + 16, v1 = ck1 >= c0 && ck1 < c0 + 16;
                    const float b0 = rpbL[v0 ? dr * 32 + (ck0 - cq + 15) : 0], b1 = rpbL[v1 ? dr * 32 + (ck1 - cq + 15) : 0];
                    p0[i] = v0 ? p0[i] * LOG2E + b0 : -1e30f; p1[i] = v1 ? p1[i] * LOG2E + b1 : -1e30f; mx = fmaxf(mx, fmaxf(p0[i], p1[i])); } }
            else {
#pragma unroll
                for (int i = 0; i < 16; ++i) { p0[i] *= LOG2E; p1[i] *= LOG2E; mx = fmaxf(mx, fmaxf(p0[i], p1[i])); } }
            mx = fmaxf(mx, __shfl_xor(mx, 32));
            const float m_new = fmaxf(m_run, mx), alpha = __builtin_amdgcn_exp2f(m_run - m_new); m_run = m_new;
            float ls = 0.f;
#pragma unroll
            for (int i = 0; i < 16; ++i) { p0[i] = __builtin_amdgcn_exp2f(p0[i] - m_new); p1[i] = __builtin_amdgcn_exp2f(p1[i] - m_new); ls += p0[i] + p1[i]; }
            l_run = l_run * alpha + ls;
            if (hi == 0) wsf[r32] = alpha;
#pragma unroll
            for (int i = 0; i < 16; ++i) { const float a = wsf[crow(i, hi)]; o0[i] *= a; o1[i] *= a; }
            bf16x8 pa[4];
            { u32x4 t; t.x = cvt_pk_bf16(p0[0], p0[1]); t.y = cvt_pk_bf16(p0[2], p0[3]); t.z = cvt_pk_bf16(p0[4], p0[5]); t.w = cvt_pk_bf16(p0[6], p0[7]); pa[0] = __builtin_bit_cast(bf16x8, t);
              t.x = cvt_pk_bf16(p0[8], p0[9]); t.y = cvt_pk_bf16(p0[10], p0[11]); t.z = cvt_pk_bf16(p0[12], p0[13]); t.w = cvt_pk_bf16(p0[14], p0[15]); pa[1] = __builtin_bit_cast(bf16x8, t);
              t.x = cvt_pk_bf16(p1[0], p1[1]); t.y = cvt_pk_bf16(p1[2], p1[3]); t.z = cvt_pk_bf16(p1[4], p1[5]); t.w = cvt_pk_bf16(p1[6], p1[7]); pa[2] = __builtin_bit_cast(bf16x8, t);
              t.x = cvt_pk_bf16(p1[8], p1[9]); t.y = cvt_pk_bf16(p1[10], p1[11]); t.z = cvt_pk_bf16(p1[12], p1[13]); t.w = cvt_pk_bf16(p1[14], p1[15]); pa[3] = __builtin_bit_cast(bf16x8, t); }
#pragma unroll
            for (int ks = 0; ks < 4; ++ks) {
                const LAS unsigned char* vp = Vs + vtb + ks * 16 * 128;
                const s16x4 a0 = vtr(vp), a1 = vtr(vp + 8 * 128), b0 = vtr(vp + 64), b1 = vtr(vp + 8 * 128 + 64);
                const bf16x8 v0 = (bf16x8){a0[0], a0[1], a0[2], a0[3], a1[0], a1[1], a1[2], a1[3]}, v1 = (bf16x8){b0[0], b0[1], b0[2], b0[3], b1[0], b1[1], b1[2], b1[3]};
                o0 = __builtin_amdgcn_mfma_f32_32x32x16_bf16(pa[ks], v0, o0, 0, 0, 0); o1 = __builtin_amdgcn_mfma_f32_32x32x16_bf16(pa[ks], v1, o1, 0, 0, 0);
            }
        }
    }
    l_run += __shfl_xor(l_run, 32);
    if (hi == 0) wsf[32 + r32] = 1.f / l_run;
    LAS bf16_t* stg = (LAS bf16_t*)(lds + L_OST + w * 4096);
#pragma unroll
    for (int i = 0; i < 16; ++i) { const int orow = crow(i, hi); const float rl = wsf[32 + orow];
        stg[orow * 64 + r32] = (bf16_t)(cvt_pk_bf16(o0[i] * rl, 0.f) & 0xffffu); stg[orow * 64 + 32 + r32] = (bf16_t)(cvt_pk_bf16(o1[i] * rl, 0.f) & 0xffffu); }
    LDS_WAIT();
#pragma unroll
    for (int i = 0; i < 4; ++i) { const int row = i * 8 + (lane >> 3), ch = lane & 7; float f[8], g[8];
        unpack8(*(const LAS u32x4*)(stg + row * 64 + ch * 8), f);
        const size_t off = (size_t)(qrow0 + row) * 1024 + h * 64 + ch * 8; unpack8(*(const u32x4*)(Sg + off), g);
        u32x4 o; o.x = cvt_pk_bf16(f[0] * g[0], f[1] * g[1]); o.y = cvt_pk_bf16(f[2] * g[2], f[3] * g[3]); o.z = cvt_pk_bf16(f[4] * g[4], f[5] * g[5]); o.w = cvt_pk_bf16(f[6] * g[6], f[7] * g[7]);
        *(u32x4*)(Qb + off) = o; }
    __syncthreads();
#undef ATT_LOAD_TILE
#undef ATT_STORE_TILE
}

__device__ __forceinline__ void phase_attn(Frame& F) {
    for (int un = F.vcu; un < 1024; un += F.G) { const int R = un & 15, h = (un >> 4) & 15, b = un >> 8; attn_unit<true>(F, b, h, R); }
    for (int un = F.vcu; un < 512; un += F.G) { const int h = un & 15, b = un >> 4; attn_unit<false>(F, b, h, 0); }
}
}
#ifndef MK_N_LAUNCHES
#define MK_N_LAUNCHES 1
#endif
constexpr int NPH = 18;
struct Args { const float* in[23]; float* out; unsigned char* ws; int ph_lo, ph_hi; };

struct WcOrder {
    int G, c; const char* GT; const char* WXB;
    __device__ bool next(int i, pg8::Unit& u) const {
        const int L = i * G + c; if (L >= 64) return false;
        u.job = L >> 3; u.pm = (L >> 2) & 1; u.pn = L & 3; const int j = u.job >> 2, g = u.job & 3;
        u.a = GT + ((size_t)u.job * 512 * 512 + (size_t)u.pm * 256 * 512) * 2;
        u.b = WXB + ((size_t)j * 1024 * 2048 + (size_t)u.pn * 256 * 2048 + g * 512) * 2;
        return true;
    }
};

__global__ void __launch_bounds__(NWAVES * 64, 2) mega_fwd(const Args args) {
    extern __shared__ __attribute__((aligned(16))) unsigned char lds_raw[];
    Frame F;
    F.lds = (LAS unsigned char*)lds_raw;
    F.tid = threadIdx.x; F.lane = F.tid & 63; F.wave = __builtin_amdgcn_readfirstlane(F.tid >> 6);
    F.G = gridDim.x; { const int bx = blockIdx.x; F.vcu = (F.G % 8 == 0) ? (bx % 8) * (F.G / 8) + bx / 8 : bx; }
    F.in = args.in;
    F.out = args.out; F.ws = args.ws; F.cx = (unsigned char*)args.out + OUT_CTX; F.mod = (float*)(args.ws + WS_MOD);
    volatile LAS unsigned* MISC = (volatile LAS unsigned*)(F.lds + MISC_OFF);
    for (int u = F.tid; u < (LDS_BYTES - LDSCTL_OFF) / 4; u += NWAVES * 64) ((LAS unsigned*)(F.lds + LDSCTL_OFF))[u] = 0u;
    __syncthreads();
    const int lo = args.ph_lo, hi = args.ph_hi;
    XcdBarrier bar; bar.bar = (unsigned*)(args.ws + WS_CTL) + CW_BAR; bar.x = 0; bar.st = nullptr;
    if (hi - lo > 1) bar = xcd_barrier_post((unsigned*)(args.ws + WS_CTL) + CW_BAR, MISC + 8);
#define IN(k) (lo <= (k) && (k) < hi)
#define SEAM(k) do { if (IN(k) && IN((k) + 1)) xcd_barrier(bar); } while (0)
    LAS unsigned char* ring = F.lds;
    bf16_t* HB = (bf16_t*)(F.ws + WS_HB); bf16_t* ACT = (bf16_t*)(F.ws + WS_ACT);
    bf16_t* BP0 = (bf16_t*)(F.cx + CX_BP0); bf16_t* BP1 = (bf16_t*)(F.ws + WS_BP1); bf16_t* WO0 = (bf16_t*)(F.cx + CX_WO0); bf16_t* WO1 = (bf16_t*)(F.ws + WS_WO1);

    if (IN(0)) {
#ifndef SKIP_PREP
 relaunder(F); phase_prep(F);
#endif
 } SEAM(0);
    if (IN(1)) {
        WcOrder S; S.G = F.G; S.c = F.vcu; S.GT = (const char*)(F.cx + CX_GT); S.WXB = (const char*)(F.cx + CX_WXB);
        epi::EpiWc E{BP0, BP1};
#ifndef SKIP_WC
        pg8::gemm_phase<epi::EpiWc, WcOrder>(ring, 512, 512, 2048, S, E);
#endif
#ifndef SKIP_HB0
        relaunder(F); phase_hb0(F, F.G > 64 ? 64 : 0);
#endif
    } SEAM(1);
#pragma unroll 1
    for (int layer = 0; layer < 4; ++layer) {
        const int kind = layer % 3, p0 = 2 + 4 * layer;
        const float* gate = F.mod + (size_t)layer * 5 * 3072 + 2048;
        const float* Xp = layer == 0 ? F.in[0] : F.out; const float* Xs = layer == 0 ? F.in[1] - (size_t)TP * D : F.out;
        if (kind == 0) {
            const int j = layer / 3;
            if (IN(p0)) { pg8::Gemm g{HB, j ? BP1 : BP0, T, 4096, 1024, 1024, 1024}; pg8::StaticOrder S; S.init(g, F.G, (int)blockIdx.x);
                epi::EpiPoolG1 E{ACT, ACT + 2 * (size_t)T * 1024, F.in[12] + j * 2048};

#ifndef SKIP_G1P
                pg8::gemm_phase<epi::EpiPoolG1, pg8::StaticOrder>(ring, 1024, 1024, 1024, S, E);
#endif
 } SEAM(p0);
            if (IN(p0 + 1)) {
#ifndef SKIP_POOL
 relaunder(F); phase_pool(F);
#endif
 } SEAM(p0 + 1);
            if (IN(p0 + 2)) { pg8::Gemm g{ACT + 2 * (size_t)T * 1024, j ? WO1 : WO0, T, 1024, 2048, 2048, 2048}; pg8::StaticOrder S; S.init(g, F.G, (int)blockIdx.x);
                epi::EpiRes E{Xp, Xs, F.out, gate};

#ifndef SKIP_G3
                pg8::gemm_phase<epi::EpiRes, pg8::StaticOrder>(ring, 2048, 2048, 2048, S, E);
#endif
 } SEAM(p0 + 2);
        } else if (kind == 1) {
            if (IN(p0)) { pg8::Gemm g{HB, (bf16_t*)(F.cx + CX_BSGU), T, 6144, 1024, 1024, 1024}; pg8::StaticOrder S; S.init(g, F.G, (int)blockIdx.x);
                epi::EpiSguG1 E{ACT, ACT + 2 * (size_t)T * 1024, (float*)(F.cx + CX_STATS)};

#ifndef SKIP_G1S
                pg8::gemm_phase<epi::EpiSguG1, pg8::StaticOrder>(ring, 1024, 1024, 1024, S, E);
#endif
 } SEAM(p0);
            if (IN(p0 + 1)) {
#ifndef SKIP_SG
 relaunder(F); phase_sg(F);
#endif
 } SEAM(p0 + 1);
            if (IN(p0 + 2)) { pg8::Gemm g{ACT, (bf16_t*)(F.cx + CX_WOSGU), T, 1024, 2048, 2048, 2048}; pg8::StaticOrder S; S.init(g, F.G, (int)blockIdx.x);
                epi::EpiRes E{Xp, Xs, F.out, gate};

#ifndef SKIP_G3
                pg8::gemm_phase<epi::EpiRes, pg8::StaticOrder>(ring, 2048, 2048, 2048, S, E);
#endif
 } SEAM(p0 + 2);
        } else {
            if (IN(p0)) { pg8::Gemm g{HB, (bf16_t*)(F.ws + WS_BNA), T, 4096, 1024, 1024, 1024}; pg8::StaticOrder S; S.init(g, F.G, (int)blockIdx.x);
                epi::EpiAttnG1 E{ACT, F.out + (size_t)T * D};

#ifndef SKIP_G1A
                pg8::gemm_phase<epi::EpiAttnG1, pg8::StaticOrder>(ring, 1024, 1024, 1024, S, E);
#endif
 } SEAM(p0);
            if (IN(p0 + 1)) {
#ifndef SKIP_ATT
 relaunder(F); att::phase_attn(F);
#endif
 } SEAM(p0 + 1);
            if (IN(p0 + 2)) { pg8::Gemm g{ACT, (bf16_t*)(F.ws + WS_WONA), T, 1024, 1024, 1024, 1024}; pg8::StaticOrder S; S.init(g, F.G, (int)blockIdx.x);
                epi::EpiRes E{Xp, Xs, F.out, gate};

#ifndef SKIP_G3
                pg8::gemm_phase<epi::EpiRes, pg8::StaticOrder>(ring, 1024, 1024, 1024, S, E);
#endif
 } SEAM(p0 + 2);
        }
        if (IN(p0 + 3)) {
#ifndef SKIP_LN
 relaunder(F); phase_ln(F, layer, layer < 3 ? layer + 1 : -1);
#endif
 } SEAM(p0 + 3);
    }
#undef IN
#undef SEAM
}

extern "C" void kernel_launch(void* const* d_in, const int* in_sizes, int n_in, void* d_out, int out_size, void* d_ws, size_t ws_size, hipStream_t stream) {
    static int grid = 0;
    if (grid == 0) {
        if (n_in != 23 || ws_size < WS_END) { fprintf(stderr, "kernel_launch: unexpected problem (n_in %d, ws %zu)\n", n_in, ws_size); grid = -1; return; }
        int dev = 0, cus = 0, per_cu = 0;
        if (hipGetDevice(&dev) != hipSuccess || hipDeviceGetAttribute(&cus, hipDeviceAttributeMultiprocessorCount, dev) != hipSuccess) { grid = -1; return; }
        if (hipFuncSetAttribute((const void*)mega_fwd, hipFuncAttributeMaxDynamicSharedMemorySize, LDS_BYTES) != hipSuccess) { fprintf(stderr, "kernel_launch: hipFuncSetAttribute failed\n"); grid = -1; return; }
        if (hipOccupancyMaxActiveBlocksPerMultiprocessor(&per_cu, (const void*)mega_fwd, NWAVES * 64, LDS_BYTES) != hipSuccess || per_cu < 1) fprintf(stderr, "kernel_launch: occupancy query says %d\n", per_cu);
        (void)hipGetLastError();
        grid = cus;
    }
    if (grid < 0) return;
    (void)hipMemsetAsync((char*)d_ws + WS_CTL, 0, CTL_ZERO_BYTES, stream);
    Args a{};
    for (int i = 0; i < 23; ++i) a.in[i] = (const float*)d_in[i];
    a.out = (float*)d_out; a.ws = (unsigned char*)d_ws;
#if MK_N_LAUNCHES == 1
    a.ph_lo = 0; a.ph_hi = NPH;
    hipLaunchKernelGGL(mega_fwd, dim3(grid), dim3(NWAVES * 64), LDS_BYTES, stream, a);
#else
    for (int p = 0; p < NPH; ++p) { a.ph_lo = p; a.ph_hi = p + 1; hipLaunchKernelGGL(mega_fwd, dim3(grid), dim3(NWAVES * 64), LDS_BYTES, stream, a); }
#endif
}
```
